# Optimizing an MI355X kernel written in HIP

```python
import math
import jax
import jax.numpy as jnp
from jax import lax
import numpy as np

D_MODEL = 2048
BATCH = 4
SEQ = 2048
DEPTH = 4
DEC_BATCH = 128
DEC_SEQ = 1
PAST_LEN = 16384
PAGE_SIZE = 128

N_MIXERS = 2
N_S5_LAYERS = (DEPTH + 1) // 2
N_ML_LAYERS = DEPTH // 2
S5_GROUP = 16
S5_GROUPS = D_MODEL // S5_GROUP
S5_STATE = 64
S5_DT_MIN = 1e-3
S5_DT_MAX = 1e-1
ML_HEADS = 4
ML_DV = D_MODEL // ML_HEADS
ML_DK = ML_DV // 2
ML_CHUNK = 128
ML_PROJ_SPLITS = [ML_HEADS * ML_DK, ML_HEADS * ML_DK, ML_HEADS * ML_DV, ML_HEADS * ML_DV, ML_HEADS, ML_HEADS]
ML_PROJ = sum(ML_PROJ_SPLITS)
D_FF = 5504
DN_ALPHA = (2.0 * DEPTH) ** 0.25
DN_BETA = (8.0 * DEPTH) ** -0.25
LN_EPS = 1e-5

kernel_name = 'hybrid_s5_mlstm_macaron_deepnorm_step'


def _layer_norm(x, g, b):
    xf = x.astype(jnp.float32)
    mu = jnp.mean(xf, axis=-1, keepdims=True)
    xc = xf - mu
    var = jnp.mean(xc * xc, axis=-1, keepdims=True)
    return (xc * lax.rsqrt(var + LN_EPS) * g + b).astype(x.dtype)


def _swiglu(x, w_gate, w_up, w_down):
    return (jax.nn.silu(x @ w_gate) * (x @ w_up)) @ w_down


def _complex_affine_combine(e1, e2):
    a1r, a1i, b1r, b1i = e1
    a2r, a2i, b2r, b2i = e2
    return (a2r * a1r - a2i * a1i,
            a2r * a1i + a2i * a1r,
            a2r * b1r - a2i * b1i + b2r,
            a2r * b1i + a2i * b1r + b2i)


def _s5_mix(u, h0_re, h0_im, a_re, a_im, log_dt, b_re, b_im, c_re, c_im, d_skip, w_glu_a, w_glu_b):
    bsz, s, _ = u.shape
    uf = u.astype(jnp.float32)
    ug = uf.reshape(bsz, s, S5_GROUPS, S5_GROUP)
    ar = a_re.astype(jnp.float32)
    ai = a_im.astype(jnp.float32)
    dt = jnp.exp(log_dt.astype(jnp.float32))[:, None]
    mag = jnp.exp(dt * ar)
    abr = mag * jnp.cos(dt * ai)
    abi = mag * jnp.sin(dt * ai)
    zr = abr - 1.0
    zi = abi
    den = ar * ar + ai * ai
    gr = (zr * ar + zi * ai) / den
    gi = (zi * ar - zr * ai) / den
    br = b_re.astype(jnp.float32)
    bi = b_im.astype(jnp.float32)
    bbr = gr[..., None] * br - gi[..., None] * bi
    bbi = gr[..., None] * bi + gi[..., None] * br
    bu_r = jnp.einsum('bsgc,gpc->bsgp', ug, bbr)
    bu_i = jnp.einsum('bsgc,gpc->bsgp', ug, bbi)
    h0r = h0_re.astype(jnp.float32)
    h0i = h0_im.astype(jnp.float32)
    bu_r = bu_r.at[:, 0].add(abr * h0r - abi * h0i)
    bu_i = bu_i.at[:, 0].add(abr * h0i + abi * h0r)
    a_r = jnp.broadcast_to(abr, bu_r.shape)
    a_i = jnp.broadcast_to(abi, bu_i.shape)
    _, _, hr, hi = lax.associative_scan(_complex_affine_combine, (a_r, a_i, bu_r, bu_i), axis=1)
    y = (jnp.einsum('bsgp,gcp->bsgc', hr, c_re.astype(jnp.float32))
         - jnp.einsum('bsgp,gcp->bsgc', hi, c_im.astype(jnp.float32)))
    y = y.reshape(bsz, s, D_MODEL) + d_skip.astype(jnp.float32) * uf
    z = jax.nn.gelu(y).astype(u.dtype)
    out = (z @ w_glu_a) * jax.nn.sigmoid(z @ w_glu_b)
    return out, hr[:, -1], hi[:, -1]


def _to_chunks(t, n_chunks, chunk):
    bsz = t.shape[0]
    t = t.reshape((bsz, n_chunks, chunk) + t.shape[2:])
    perm = (1, 0, 3, 2) + tuple(range(4, t.ndim))
    return jnp.transpose(t, perm)


def _mlstm_mix(x, c0, n0, m0, w_in, b_i, b_f, norm_g, w_out):
    bsz, s, _ = x.shape
    proj = x @ w_in
    cuts = [int(c) for c in np.cumsum(ML_PROJ_SPLITS)[:-1]]
    q, k, v, o_pre, i_pre, f_pre = jnp.split(proj, cuts, axis=-1)
    q = q.reshape(bsz, s, ML_HEADS, ML_DK).astype(jnp.float32)
    k = k.reshape(bsz, s, ML_HEADS, ML_DK).astype(jnp.float32) * (ML_DK ** -0.5)
    v = v.reshape(bsz, s, ML_HEADS, ML_DV).astype(jnp.float32)
    ig = (i_pre + b_i).astype(jnp.float32)
    lf = jax.nn.log_sigmoid((f_pre + b_f).astype(jnp.float32))
    chunk = math.gcd(s, ML_CHUNK)
    n_chunks = s // chunk
    xs = (_to_chunks(q, n_chunks, chunk), _to_chunks(k, n_chunks, chunk), _to_chunks(v, n_chunks, chunk),
          _to_chunks(ig, n_chunks, chunk), _to_chunks(lf, n_chunks, chunk))
    causal = jnp.tril(jnp.ones((chunk, chunk), dtype=bool))

    def step(carry, inp):
        c, n, m = carry
        qc, kc, vc, igc, lfc = inp
        bcum = jnp.cumsum(lfc, axis=-1)
        inter = bcum + m[..., None]
        dmat = bcum[..., :, None] - bcum[..., None, :] + igc[..., None, :]
        dmat = jnp.where(causal, dmat, -jnp.inf)
        mt = jnp.maximum(inter, jnp.max(dmat, axis=-1))
        wts = jnp.exp(dmat - mt[..., None])
        sc = jnp.einsum('bhtd,bhsd->bhts', qc, kc) * wts
        scale = jnp.exp(inter - mt)
        num = scale[..., None] * jnp.einsum('bhtd,bhdv->bhtv', qc, c) + jnp.einsum('bhts,bhsv->bhtv', sc, vc)
        den = scale * jnp.einsum('bhtd,bhd->bht', qc, n) + jnp.sum(sc, axis=-1)
        h = num / jnp.maximum(jnp.abs(den), jnp.exp(-mt))[..., None]
        m_last = mt[..., -1]
        dec = jnp.exp(bcum[..., -1:] - bcum + igc - m_last[..., None])
        carry_scale = jnp.exp(bcum[..., -1] + m - m_last)
        c_new = carry_scale[..., None, None] * c + jnp.einsum('bhs,bhsd,bhsv->bhdv', dec, kc, vc)
        n_new = carry_scale[..., None] * n + jnp.einsum('bhs,bhsd->bhd', dec, kc)
        return (c_new, n_new, m_last), h

    init = (c0.astype(jnp.float32), n0.astype(jnp.float32), m0.astype(jnp.float32))
    (c_f, n_f, m_f), hs = lax.scan(step, init, xs)
    h = jnp.transpose(hs, (1, 0, 3, 2, 4)).reshape(bsz, s, ML_HEADS, ML_DV)
    mu = jnp.mean(h, axis=-1, keepdims=True)
    hc = h - mu
    var = jnp.mean(hc * hc, axis=-1, keepdims=True)
    hn = hc * lax.rsqrt(var + LN_EPS) * norm_g.astype(jnp.float32).reshape(ML_HEADS, ML_DV)
    o = jax.nn.sigmoid(o_pre.astype(jnp.float32)).reshape(bsz, s, ML_HEADS, ML_DV)
    out = (o * hn).reshape(bsz, s, ML_HEADS * ML_DV).astype(x.dtype) @ w_out
    return out, c_f, n_f, m_f


def _trunk(x, s5_re0, s5_im0, ml_c0, ml_n0, ml_m0,
           ln_g, ln_b, ffn_w_gate, ffn_w_up, ffn_w_down,
           s5_a_re, s5_a_im, s5_log_dt, s5_b_re, s5_b_im, s5_c_re, s5_c_im, s5_d, s5_w_a, s5_w_b,
           ml_w_in, ml_b_i, ml_b_f, ml_norm_g, ml_w_out):
    s5_r, s5_i, ml_c, ml_n, ml_m = [], [], [], [], []
    for li in range(DEPTH):
        x = _layer_norm(DN_ALPHA * x + 0.5 * _swiglu(x, ffn_w_gate[li, 0], ffn_w_up[li, 0], ffn_w_down[li, 0]),
                        ln_g[li, 0], ln_b[li, 0])
        j = li // N_MIXERS
        if li % N_MIXERS == 0:
            mix, hr, hi = _s5_mix(x, s5_re0[j], s5_im0[j], s5_a_re[j], s5_a_im[j], s5_log_dt[j],
                                  s5_b_re[j], s5_b_im[j], s5_c_re[j], s5_c_im[j], s5_d[j], s5_w_a[j], s5_w_b[j])
            s5_r.append(hr)
            s5_i.append(hi)
        else:
            mix, c, n, m = _mlstm_mix(x, ml_c0[j], ml_n0[j], ml_m0[j], ml_w_in[j], ml_b_i[j], ml_b_f[j],
                                      ml_norm_g[j], ml_w_out[j])
            ml_c.append(c)
            ml_n.append(n)
            ml_m.append(m)
        x = _layer_norm(DN_ALPHA * x + mix, ln_g[li, 1], ln_b[li, 1])
        x = _layer_norm(DN_ALPHA * x + 0.5 * _swiglu(x, ffn_w_gate[li, 1], ffn_w_up[li, 1], ffn_w_down[li, 1]),
                        ln_g[li, 2], ln_b[li, 2])
    return x, jnp.stack(s5_r), jnp.stack(s5_i), jnp.stack(ml_c), jnp.stack(ml_n), jnp.stack(ml_m)


def setup_inputs(seed: int = 0) -> dict:
    key = jax.random.key(seed)
    ks = iter(jax.random.split(key, 40))
    nrm = lambda shape, scale: jax.random.normal(next(ks), shape, jnp.float32) * scale
    g, p, h = S5_GROUPS, S5_STATE, ML_HEADS
    inp = {}
    inp['x_prompt'] = nrm((BATCH, SEQ, D_MODEL), 1.0)
    inp['x_sample'] = nrm((DEC_BATCH, DEC_SEQ, D_MODEL), 1.0)
    inp['state_s5_re'] = nrm((N_S5_LAYERS, DEC_BATCH, g, p), 0.5)
    inp['state_s5_im'] = nrm((N_S5_LAYERS, DEC_BATCH, g, p), 0.5)
    inp['state_mlstm_C'] = nrm((N_ML_LAYERS, DEC_BATCH, h, ML_DK, ML_DV), ML_DK ** -0.5)
    inp['state_mlstm_n'] = nrm((N_ML_LAYERS, DEC_BATCH, h, ML_DK), ML_DK ** -0.5)
    inp['state_mlstm_m'] = nrm((N_ML_LAYERS, DEC_BATCH, h), 1.0)
    inp['ln_g'] = 1.0 + nrm((DEPTH, 3, D_MODEL), 0.02)
    inp['ln_b'] = nrm((DEPTH, 3, D_MODEL), 0.02)
    inp['ffn_w_gate'] = nrm((DEPTH, 2, D_MODEL, D_FF), D_MODEL ** -0.5)
    inp['ffn_w_up'] = nrm((DEPTH, 2, D_MODEL, D_FF), D_MODEL ** -0.5)
    inp['ffn_w_down'] = nrm((DEPTH, 2, D_FF, D_MODEL), D_FF ** -0.5 * DN_BETA)
    inp['s5_a_re'] = -0.5 + nrm((N_S5_LAYERS, g, p), 0.01)
    inp['s5_a_im'] = jnp.pi * jnp.arange(p, dtype=jnp.float32) + nrm((N_S5_LAYERS, g, p), 0.01)
    inp['s5_log_dt'] = jax.random.uniform(next(ks), (N_S5_LAYERS, g), jnp.float32,
                                          math.log(S5_DT_MIN), math.log(S5_DT_MAX))
    inp['s5_b_re'] = nrm((N_S5_LAYERS, g, p, S5_GROUP), (2.0 * S5_GROUP) ** -0.5)
    inp['s5_b_im'] = nrm((N_S5_LAYERS, g, p, S5_GROUP), (2.0 * S5_GROUP) ** -0.5)
    inp['s5_c_re'] = nrm((N_S5_LAYERS, g, S5_GROUP, p), p ** -0.5)
    inp['s5_c_im'] = nrm((N_S5_LAYERS, g, S5_GROUP, p), p ** -0.5)
    inp['s5_d'] = nrm((N_S5_LAYERS, D_MODEL), 1.0)
    inp['s5_w_a'] = nrm((N_S5_LAYERS, D_MODEL, D_MODEL), D_MODEL ** -0.5 * DN_BETA)
    inp['s5_w_b'] = nrm((N_S5_LAYERS, D_MODEL, D_MODEL), D_MODEL ** -0.5)
    inp['ml_w_in'] = nrm((N_ML_LAYERS, D_MODEL, ML_PROJ), D_MODEL ** -0.5)
    inp['ml_b_i'] = nrm((N_ML_LAYERS, h), 0.1)
    inp['ml_b_f'] = jnp.linspace(3.0, 6.0, h, dtype=jnp.float32) + nrm((N_ML_LAYERS, h), 0.1)
    inp['ml_norm_g'] = 1.0 + nrm((N_ML_LAYERS, h * ML_DV), 0.02)
    inp['ml_w_out'] = nrm((N_ML_LAYERS, h * ML_DV, D_MODEL), (h * ML_DV) ** -0.5 * DN_BETA)
    return inp


def reference(x_prompt, x_sample, state_s5_re, state_s5_im, state_mlstm_C, state_mlstm_n, state_mlstm_m,
              ln_g, ln_b, ffn_w_gate, ffn_w_up, ffn_w_down,
              s5_a_re, s5_a_im, s5_log_dt, s5_b_re, s5_b_im, s5_c_re, s5_c_im, s5_d, s5_w_a, s5_w_b,
              ml_w_in, ml_b_i, ml_b_f, ml_norm_g, ml_w_out):
    weights = (ln_g, ln_b, ffn_w_gate, ffn_w_up, ffn_w_down,
               s5_a_re, s5_a_im, s5_log_dt, s5_b_re, s5_b_im, s5_c_re, s5_c_im, s5_d, s5_w_a, s5_w_b,
               ml_w_in, ml_b_i, ml_b_f, ml_norm_g, ml_w_out)
    bp = x_prompt.shape[0]
    z_s5 = jnp.zeros((N_S5_LAYERS, bp, S5_GROUPS, S5_STATE), jnp.float32)
    z_c = jnp.zeros((N_ML_LAYERS, bp, ML_HEADS, ML_DK, ML_DV), jnp.float32)
    z_n = jnp.zeros((N_ML_LAYERS, bp, ML_HEADS, ML_DK), jnp.float32)
    z_m = jnp.zeros((N_ML_LAYERS, bp, ML_HEADS), jnp.float32)
    y_prompt, p_s5_re, p_s5_im, p_c, p_n, p_m = _trunk(x_prompt, z_s5, z_s5, z_c, z_n, z_m, *weights)
    y_sample, s_s5_re, s_s5_im, s_c, s_n, s_m = _trunk(x_sample, state_s5_re, state_s5_im, state_mlstm_C,
                                                       state_mlstm_n, state_mlstm_m, *weights)
    return (y_prompt, y_sample, p_s5_re, p_s5_im, p_c, p_n, p_m, s_s5_re, s_s5_im, s_c, s_n, s_m)
```

```cpp
#include <hip/hip_runtime.h>
#include <cstdio>
#include <cstdint>
#ifndef MK_ONE_LAUNCH
#define MK_ONE_LAUNCH 1
#endif
namespace pg8 {
#define PG8_LAS __attribute__((address_space(3)))
typedef unsigned short bf16_t;
typedef short bf16x8 __attribute__((ext_vector_type(8)));
typedef float f32x4 __attribute__((ext_vector_type(4)));
typedef unsigned u32x4 __attribute__((ext_vector_type(4)));
constexpr int BM = 256, BK = 64, HALF = 128, HTB = HALF * BK * 2  , STAGE_BYTES = 8 * HTB, NXCD = 8, WGM = 8;

__host__ __device__ __forceinline__ int lds_byte(int r, int c) { const int st = (r >> 4) * 2 + (c >> 5), rr = r & 15, cc = c & 31, ob = rr * 64 + cc * 2; return st * 1024 + (ob ^ (((ob >> 9) & 1) << 5)); }
__host__ __device__ __forceinline__ void stage_rc(int b, int& R, int& C) { const int st = b / 1024, sb = b % 1024, swz = sb ^ (((sb >> 9) & 1) << 5); R = (st >> 1) * 16 + swz / 64; C = (st & 1) * 32 + (swz % 64) / 2; }
__host__ __device__ __forceinline__ int perm32(int rho) { const int n = rho >> 4, i = rho & 15; return 8 * (i >> 2) + 4 * n + (i & 3); }

struct Unit { int pm, pn; };
struct Gemm { const bf16_t* A; const bf16_t* Bt; int M, N, K; };

struct StaticOrder {
    int nM, nN, nwg, G, c;
    __host__ __device__ void init(int M, int N, int G_, int c_) { nM = M / BM; nN = N / BM; nwg = nM * nN; G = G_; c = c_; }
    __host__ __device__ bool next(int i, Unit& u) const {
        const long L = (long)i * G + c; if (L >= nwg) return false;
        int wgid = (int)L; { const int q = nwg / NXCD, r = nwg % NXCD, xcd = wgid % NXCD, off = wgid / NXCD; wgid = (xcd < r ? xcd * (q + 1) : r * (q + 1) + (xcd - r) * q) + off; }
        const int nig = WGM * nN, gid = wgid / nig, fm = gid * WGM, gsz = (nM - fm) < WGM ? (nM - fm) : WGM;
        u.pm = fm + ((wgid % nig) % gsz); u.pn = (wgid % nig) / gsz; return true;
    }
    __device__ __forceinline__ void a_ready(const Unit&) const {}
    __device__ __forceinline__ void done(const Unit&) const {}
};
__device__ __forceinline__ unsigned cvt_pk_bf16(float lo, float hi) { unsigned r; asm volatile("v_cvt_pk_bf16_f32 %0, %1, %2" : "=v"(r) : "v"(lo), "v"(hi)); return r; }
typedef float f32x2 __attribute__((ext_vector_type(2)));
__device__ __forceinline__ float fast_sigmoid(float x) { return __builtin_amdgcn_rcpf(1.0f + __expf(-x)); }
constexpr float DN_ALPHA = 1.681792830507429f;

struct EpiBf16 {
    static constexpr bool PERM = true, AFTER_DRAIN = false;
    bf16_t* O; int ldc;
    __device__ __forceinline__ void operator()(const f32x4 (&acc)[2][2][4][2], const Unit& u, int wr, int wc, int fr, int fq) const {
        const int row0 = u.pm * BM + wr * 64 + fr, col0 = u.pn * BM + wc * 32 + 8 * fq;
#pragma unroll
        for (int ai = 0; ai < 2; ++ai)
#pragma unroll
            for (int m = 0; m < 4; ++m) { bf16_t* rowp = O + (size_t)(row0 + ai * HALF + m * 16) * ldc + col0;
#pragma unroll
                for (int bj = 0; bj < 2; ++bj) { const f32x4 v0 = acc[ai][bj][m][0], v1 = acc[ai][bj][m][1];
                    u32x4 w; w.x = cvt_pk_bf16(v0[0], v0[1]); w.y = cvt_pk_bf16(v0[2], v0[3]); w.z = cvt_pk_bf16(v1[0], v1[1]); w.w = cvt_pk_bf16(v1[2], v1[3]);
                    *(u32x4*)(rowp + bj * HALF) = w; } }
    }
};
struct EpiSwiGLU {
    static constexpr bool PERM = true, AFTER_DRAIN = false;
    bf16_t* O; int ldc;
    __device__ __forceinline__ void operator()(const f32x4 (&acc)[2][2][4][2], const Unit& u, int wr, int wc, int fr, int fq) const {
        const int row0 = u.pm * BM + wr * 64 + fr, col0 = u.pn * HALF + wc * 32 + 8 * fq;
#pragma unroll
        for (int ai = 0; ai < 2; ++ai)
#pragma unroll
            for (int m = 0; m < 4; ++m) { bf16_t* rowp = O + (size_t)(row0 + ai * HALF + m * 16) * ldc + col0;
                float hv[8];
#pragma unroll
                for (int n = 0; n < 2; ++n)
#pragma unroll
                    for (int j = 0; j < 4; ++j) { const float g = acc[ai][0][m][n][j], up = acc[ai][1][m][n][j]; hv[n * 4 + j] = g * fast_sigmoid(g) * up; }
                u32x4 w; w.x = cvt_pk_bf16(hv[0], hv[1]); w.y = cvt_pk_bf16(hv[2], hv[3]); w.z = cvt_pk_bf16(hv[4], hv[5]); w.w = cvt_pk_bf16(hv[6], hv[7]);
                *(u32x4*)rowp = w; }
    }
};
struct EpiRes {
    static constexpr bool PERM = false, AFTER_DRAIN = false;
    const float* X; float* Y; float s;
    __device__ __forceinline__ void operator()(const f32x4 (&acc)[2][2][4][2], const Unit& u, int wr, int wc, int fr, int fq) const {
        const int row0 = u.pm * BM + wr * 64 + fr, col0 = u.pn * BM + wc * 32 + 4 * fq;
#pragma unroll
        for (int ai = 0; ai < 2; ++ai)
#pragma unroll
            for (int m = 0; m < 4; ++m) { const size_t off = (size_t)(row0 + ai * HALF + m * 16) * 2048 + col0;
#pragma unroll
                for (int bj = 0; bj < 2; ++bj)
#pragma unroll
                    for (int n = 0; n < 2; ++n) { const f32x4 x = *(const f32x4*)(X + off + bj * HALF + n * 16);
                        *(f32x4*)(Y + off + bj * HALF + n * 16) = x * DN_ALPHA + acc[ai][bj][m][n] * s; }
                asm volatile("" ::: "memory"); }
    }
};
struct EpiGLU {
    static constexpr bool PERM = true, AFTER_DRAIN = false;
    const float* X; float* Y;
    __device__ __forceinline__ void operator()(const f32x4 (&acc)[2][2][4][2], const Unit& u, int wr, int wc, int fr, int fq) const {
        const int row0 = u.pm * BM + wr * 64 + fr, col0 = u.pn * HALF + wc * 32 + 8 * fq;
#pragma unroll
        for (int ai = 0; ai < 2; ++ai)
#pragma unroll
            for (int m = 0; m < 4; ++m) { const size_t off = (size_t)(row0 + ai * HALF + m * 16) * 2048 + col0;
#pragma unroll
                for (int n = 0; n < 2; ++n) { const f32x4 x = *(const f32x4*)(X + off + 4 * n); const f32x4 a = acc[ai][0][m][n], b = acc[ai][1][m][n]; f32x4 o;
#pragma unroll
                    for (int j = 0; j < 4; ++j) o[j] = x[j] * DN_ALPHA + a[j] * fast_sigmoid(b[j]);
                    *(f32x4*)(Y + off + 4 * n) = o; }
                asm volatile("" ::: "memory"); }
    }
};
template <class Epi, class Sched, bool ALIGN_EPI = false, bool SP2 = false>
__device__ __forceinline__ void gemm_phase(PG8_LAS unsigned char* lds, const Gemm g, const Sched& S, const Epi& E) {
    int tid_ = threadIdx.x; asm volatile("" : "+v"(tid_));
    const int tid = tid_, wid = __builtin_amdgcn_readfirstlane(tid >> 6), lane = tid & 63, wr = wid >> 2, wc = wid & 3, fr = lane & 15, fq = lane >> 4;
    const int K = g.K, nt = K / BK;
    unsigned voffA[2], voffB[2];
#pragma unroll
    for (int i = 0; i < 2; ++i) { int R, C; stage_rc(tid * 16 + i * 8192, R, C); const int Rb = Epi::PERM ? ((R & ~31) + perm32(R & 31)) : R;
        voffA[i] = (unsigned)(R * K + C) * 2u; voffB[i] = (unsigned)(Rb * K + C) * 2u; }
    const size_t kstep = (size_t)(BK * 2);
    const size_t hstep = (size_t)HALF * K * 2;
    const size_t tstep = 2 * hstep;
    const unsigned ldsw = (unsigned)wid * 1024u;
    const int aoff = lds_byte(wr * 64 + fr, fq * 8), boff = lds_byte(wc * 32 + fr, fq * 8);
#define PG8_SA(b, h) (((b) * 2 + (h)) * HTB)
#define PG8_SB(b, h) ((4 + (b) * 2 + (h)) * HTB)
#define PG8_STAGE(bufoff, gbase, voff) do { _Pragma("unroll") for (int _i = 0; _i < 2; ++_i) \
        __builtin_amdgcn_global_load_lds((const unsigned*)((const char*)(gbase) + (voff)[_i]), (PG8_LAS unsigned*)(lds + (bufoff) + ldsw + _i * 8192), 16, 0, 0); } while (0)
#define PG8_LDA(dst, b, h) do { _Pragma("unroll") for (int m = 0; m < 4; ++m) _Pragma("unroll") for (int k = 0; k < 2; ++k) dst[m][k] = *(const PG8_LAS bf16x8*)(lds + PG8_SA(b, h) + aoff + m * 2048 + k * 1024); } while (0)
#define PG8_LDB(dst, b, h) do { _Pragma("unroll") for (int n = 0; n < 2; ++n) _Pragma("unroll") for (int k = 0; k < 2; ++k) dst[n][k] = *(const PG8_LAS bf16x8*)(lds + PG8_SB(b, h) + boff + n * 2048 + k * 1024); } while (0)
#define PG8_MMA(ai, bj, At, Bt) do { __builtin_amdgcn_s_setprio(1); _Pragma("unroll") for (int m = 0; m < 4; ++m) _Pragma("unroll") for (int n = 0; n < 2; ++n) _Pragma("unroll") for (int k = 0; k < 2; ++k) \
        acc[ai][bj][m][n] = __builtin_amdgcn_mfma_f32_16x16x32_bf16(Bt[n][k], At[m][k], acc[ai][bj][m][n], 0, 0, 0); __builtin_amdgcn_s_setprio(0); } while (0)
#define PG8_WAIT_V(n) asm volatile("s_waitcnt vmcnt(" #n ")" ::: "memory")
#define PG8_WAIT_L(n) asm volatile("s_waitcnt lgkmcnt(" #n ")" ::: "memory")
#define PG8_BAR __builtin_amdgcn_s_barrier()
#define PG8_SCHED __builtin_amdgcn_sched_barrier(0)
    Unit cur, nxt; int ui = 0;
    if (!S.next(0, cur)) return;
    f32x4 acc[2][2][4][2];
#pragma unroll
    for (int a = 0; a < 2; ++a)
#pragma unroll
        for (int b = 0; b < 2; ++b)
#pragma unroll
            for (int m = 0; m < 4; ++m)
#pragma unroll
                for (int n = 0; n < 2; ++n) acc[a][b][m][n] = (f32x4){0.f, 0.f, 0.f, 0.f};
    bf16x8 At[4][2], B0[2][2], B1[2][2];
    const char* cA = (const char*)g.A + (size_t)cur.pm * tstep; const char* cB = (const char*)g.Bt + (size_t)cur.pn * tstep;
    S.a_ready(cur);
    if constexpr (SP2) {
        PG8_STAGE(PG8_SB(0, 0), cB, voffB); PG8_STAGE(PG8_SB(0, 1), cB + hstep, voffB); PG8_STAGE(PG8_SA(0, 0), cA, voffA); PG8_STAGE(PG8_SA(0, 1), cA + hstep, voffA);
        if (wr == 1) PG8_BAR;
        PG8_WAIT_V(2); PG8_BAR;
        PG8_STAGE(PG8_SB(1, 0), cB + kstep, voffB); PG8_STAGE(PG8_SA(1, 0), cA + kstep, voffA); PG8_STAGE(PG8_SB(1, 1), cB + hstep + kstep, voffB);
        PG8_WAIT_V(6); PG8_BAR;
    } else {
        PG8_STAGE(PG8_SB(0, 0), cB, voffB); PG8_STAGE(PG8_SA(0, 0), cA, voffA); PG8_STAGE(PG8_SB(0, 1), cB + hstep, voffB); PG8_STAGE(PG8_SA(0, 1), cA + hstep, voffA);
        if (wr == 1) PG8_BAR;
        PG8_WAIT_V(4); PG8_BAR;
        PG8_STAGE(PG8_SB(1, 0), cB + kstep, voffB); PG8_STAGE(PG8_SA(1, 0), cA + kstep, voffA); PG8_STAGE(PG8_SB(1, 1), cB + hstep + kstep, voffB);
        PG8_WAIT_V(6); PG8_BAR;
    }
    for (;;) {
        const bool has_next = S.next(ui + 1, nxt);
        const char* nA = has_next ? (const char*)g.A + (size_t)nxt.pm * tstep : cA; const char* nB = has_next ? (const char*)g.Bt + (size_t)nxt.pn * tstep : cB;
        for (int t = 0; t < nt; t += 2) {
            const bool last = (t == nt - 2);
            const char* a1 = cA + (size_t)(t + 1) * kstep;
            const char* a2 = last ? nA : cA + (size_t)(t + 2) * kstep; const char* b2 = last ? nB : cB + (size_t)(t + 2) * kstep;
            const char* a3 = a2 + kstep; const char* b3 = b2 + kstep;
            if (last && has_next) S.a_ready(nxt);
            if constexpr (SP2) {
            PG8_LDB(B0, 0, 0); PG8_LDB(B1, 0, 1); PG8_SCHED; PG8_LDA(At, 0, 0); PG8_STAGE(PG8_SA(1, 1), a1 + hstep, voffA);
            PG8_WAIT_V(8); PG8_WAIT_L(0); PG8_BAR; PG8_MMA(0, 0, At, B0); PG8_MMA(0, 1, At, B1); PG8_BAR; PG8_SCHED;
            PG8_LDA(At, 0, 1); PG8_STAGE(PG8_SB(0, 0), b2, voffB); PG8_STAGE(PG8_SB(0, 1), b2 + hstep, voffB); PG8_STAGE(PG8_SA(0, 0), a2, voffA);
            PG8_WAIT_V(8); PG8_WAIT_L(0); PG8_BAR; PG8_MMA(1, 0, At, B0); PG8_MMA(1, 1, At, B1); PG8_BAR; PG8_SCHED;
            PG8_LDB(B0, 1, 0); PG8_LDB(B1, 1, 1); PG8_SCHED; PG8_LDA(At, 1, 0); PG8_STAGE(PG8_SA(0, 1), a2 + hstep, voffA);
            PG8_WAIT_V(8); PG8_WAIT_L(0); PG8_BAR; PG8_MMA(0, 0, At, B0); PG8_MMA(0, 1, At, B1); PG8_BAR; PG8_SCHED;
            PG8_LDA(At, 1, 1); PG8_STAGE(PG8_SB(1, 0), b3, voffB); PG8_STAGE(PG8_SB(1, 1), b3 + hstep, voffB); PG8_STAGE(PG8_SA(1, 0), a3, voffA);
            PG8_WAIT_V(8); PG8_WAIT_L(0); PG8_BAR; PG8_MMA(1, 0, At, B0); PG8_MMA(1, 1, At, B1); PG8_BAR; PG8_SCHED;
            } else {
            PG8_LDB(B0, 0, 0); PG8_SCHED; PG8_LDA(At, 0, 0); PG8_STAGE(PG8_SA(1, 1), a1 + hstep, voffA);
            PG8_WAIT_L(8); PG8_BAR; PG8_WAIT_L(0); PG8_MMA(0, 0, At, B0); PG8_BAR; PG8_SCHED;
            PG8_LDB(B1, 0, 1); PG8_STAGE(PG8_SB(0, 0), b2, voffB);
            PG8_BAR; PG8_WAIT_L(0); PG8_MMA(0, 1, At, B1); PG8_BAR;
            PG8_LDA(At, 0, 1); PG8_STAGE(PG8_SA(0, 0), a2, voffA);
            PG8_BAR; PG8_WAIT_L(0); PG8_MMA(1, 0, At, B0); PG8_BAR; PG8_SCHED;
            PG8_STAGE(PG8_SB(0, 1), b2 + hstep, voffB);
            PG8_WAIT_V(6); PG8_BAR; PG8_MMA(1, 1, At, B1); PG8_BAR;
            PG8_LDB(B0, 1, 0); PG8_SCHED; PG8_LDA(At, 1, 0); PG8_STAGE(PG8_SA(0, 1), a2 + hstep, voffA);
            PG8_WAIT_L(8); PG8_BAR; PG8_WAIT_L(0); PG8_MMA(0, 0, At, B0); PG8_BAR; PG8_SCHED;
            PG8_LDB(B1, 1, 1); PG8_STAGE(PG8_SB(1, 0), b3, voffB);
            PG8_BAR; PG8_WAIT_L(0); PG8_MMA(0, 1, At, B1); PG8_BAR;
            PG8_LDA(At, 1, 1); PG8_STAGE(PG8_SA(1, 0), a3, voffA);
            PG8_BAR; PG8_WAIT_L(0); PG8_MMA(1, 0, At, B0); PG8_BAR; PG8_SCHED;
            PG8_STAGE(PG8_SB(1, 1), b3 + hstep, voffB);
            PG8_WAIT_V(6); PG8_BAR; PG8_MMA(1, 1, At, B1); PG8_BAR;
            }
        }
        if constexpr (ALIGN_EPI) { if (wr == 0) PG8_BAR; }
        if constexpr (!Epi::AFTER_DRAIN) { E(acc, cur, wr, wc, fr, fq); S.done(cur); }
        if (!has_next) break;
#pragma unroll
        for (int a = 0; a < 2; ++a)
#pragma unroll
            for (int b = 0; b < 2; ++b)
#pragma unroll
                for (int m = 0; m < 4; ++m)
#pragma unroll
                    for (int n = 0; n < 2; ++n) acc[a][b][m][n] = (f32x4){0.f, 0.f, 0.f, 0.f};
        cur = nxt; cA = nA; cB = nB; ++ui;
        if constexpr (ALIGN_EPI) { if (wr == 1) PG8_BAR; }
    }
    PG8_WAIT_V(0);
    if constexpr (!ALIGN_EPI) { if (wr == 0) PG8_BAR; }
    PG8_BAR;
    if constexpr (Epi::AFTER_DRAIN) { E.fused(acc, cur, wr, wc, fr, fq, lds, wid, lane); S.done(cur); }
#undef PG8_SA
#undef PG8_SB
#undef PG8_STAGE
#undef PG8_LDA
#undef PG8_LDB
#undef PG8_MMA
#undef PG8_WAIT_V
#undef PG8_WAIT_L
#undef PG8_BAR
#undef PG8_SCHED
}
}
#define GAS __attribute__((address_space(1)))
#define LAS __attribute__((address_space(3)))
#define XB_TMO      128
#define XB_XCNT(j)  (256  + 64 * (j))
#define XB_XSUB(j)  (1280 + 64 * (j))
#define XB_XGEN(j)  (2304 + 64 * (j))
#define XB_TOP      3328
#define XB_TOPGEN   3392
#define XCD_BAR_WORDS 3456
#define XB_SPIN_CAP (1u << 18)

__device__ __forceinline__ unsigned xb_ld(unsigned* p)              { return __hip_atomic_load(p, __ATOMIC_RELAXED, __HIP_MEMORY_SCOPE_AGENT); }
__device__ __forceinline__ unsigned xb_add(unsigned* p, unsigned v) { return __hip_atomic_fetch_add(p, v, __ATOMIC_RELAXED, __HIP_MEMORY_SCOPE_AGENT); }
__device__ __forceinline__ unsigned xb_xcc_id() { return (unsigned)__builtin_amdgcn_s_getreg((3 << 11) | 20) & 0xFu; }
#define XB_SPIN(cond, bar) do { unsigned _sp = 0; while (cond) { __builtin_amdgcn_s_sleep(1); \
    if ((++_sp & 255u) == 0u) { if (xb_ld(&(bar)[XB_TMO])) break; if (_sp > XB_SPIN_CAP) { atomicAdd(&(bar)[XB_TMO], 1u); break; } } } } while (0)

struct XcdBarrier {
    unsigned* bar; unsigned x;
    volatile LAS unsigned* st;
};

__device__ __forceinline__ XcdBarrier xcd_barrier_post(unsigned* bar, volatile LAS unsigned* st) {
    XcdBarrier b; b.bar = bar; b.x = xb_xcc_id(); b.st = st;
    if (threadIdx.x == 0) (void)xb_add(&bar[XB_XCNT(b.x)], 1u);
    return b;
}
__device__ __forceinline__ void xcd_barrier_complete(unsigned* bar, unsigned x, unsigned& nloc, unsigned& nx) {
    const unsigned G = gridDim.x * gridDim.y * gridDim.z;
    unsigned sum, cnt, mine, sp = 0u;
    for (;;) {
        sum = 0u; cnt = 0u; mine = 0u;
#pragma unroll
        for (unsigned j = 0; j < 16; ++j) { const unsigned c = xb_ld(&bar[XB_XCNT(j)]); sum += c; cnt += (c > 0u) ? 1u : 0u; mine = (j == x) ? c : mine; }
        if (sum == G) break;
        __builtin_amdgcn_s_sleep(1);
        if ((++sp & 255u) == 0u) { if (xb_ld(&bar[XB_TMO])) break; if (sp > XB_SPIN_CAP) { atomicAdd(&bar[XB_TMO], 1u); break; } }
    }
    nloc = mine > 0u ? mine : 1u; nx = cnt > 0u ? cnt : 1u;
}

__device__ __forceinline__ void xcd_barrier(const XcdBarrier& b) {
    asm volatile("s_waitcnt vmcnt(0)" ::: "memory");
    __syncthreads();
    if (threadIdx.x == 0) {
        unsigned* bar = b.bar;
        __builtin_amdgcn_s_waitcnt(0);
        unsigned nloc = b.st[0], nx = b.st[1];
        if (nloc == 0u) { xcd_barrier_complete(bar, b.x, nloc, nx); b.st[0] = nloc; b.st[1] = nx; }
        const unsigned old = xb_add(&bar[XB_XSUB(b.x)], 1u);
        const unsigned gen = old / nloc;
        if (old + 1u == (gen + 1u) * nloc) {
            __builtin_amdgcn_fence(__ATOMIC_RELEASE, "agent");
            asm volatile("s_waitcnt vmcnt(0)" ::: "memory");
            const unsigned og = xb_add(&bar[XB_TOP], 1u);
            const unsigned tg = og / nx;
            if (og + 1u == (tg + 1u) * nx) xb_add(&bar[XB_TOPGEN], 1u);
            else XB_SPIN(xb_ld(&bar[XB_TOPGEN]) == tg, bar);
            __builtin_amdgcn_fence(__ATOMIC_ACQUIRE, "agent");
            xb_add(&bar[XB_XGEN(b.x)], 1u);
            asm volatile("s_waitcnt vmcnt(0)" ::: "memory");
        } else {
            XB_SPIN(xb_ld(&bar[XB_XGEN(b.x)]) == gen, bar);
            __builtin_amdgcn_fence(__ATOMIC_ACQUIRE, "agent");
            asm volatile("s_waitcnt vmcnt(0)" ::: "memory");
        }
    }
    __syncthreads();
}
constexpr int NWAVES = 8;
#define GAS __attribute__((address_space(1)))
#define LAS __attribute__((address_space(3)))
typedef unsigned short bf16;
typedef unsigned v4u __attribute__((ext_vector_type(4)));
typedef unsigned v2u __attribute__((ext_vector_type(2)));
typedef float f32x4 __attribute__((ext_vector_type(4)));
typedef float f32x2 __attribute__((ext_vector_type(2)));
typedef short bf16x8 __attribute__((ext_vector_type(8)));

constexpr int D = 2048, NB = 4, SEQ = 2048, MPROMPT = NB * SEQ, NDEC = 128, MTOK = MPROMPT + NDEC, MP = 8448, DFF = 5504;
constexpr int S5G = 128, S5P = 64, S5C = 16;
constexpr int NH = 4, DK = 256, DV = 512, NPROJ = 6152, NPM = 6144;
constexpr float LN_EPS = 1e-5f;
constexpr int NSB = MPROMPT / 16;
constexpr size_t O_YP = 0, O_YS = 16777216, O_PS5R = 17039360, O_PS5I = 17104896, O_PC = 17170432, O_PN = 21364736, O_PM = 21372928,
                 O_SS5R = 21372960, O_SS5I = 23470112, O_SC = 25567264, O_SN = 159784992, O_SM = 160047136, O_END = 160048160;
constexpr size_t MiB = 1u << 20;
constexpr size_t WS_CTL = 0, CTL_ZERO_BYTES = 1 * MiB;
constexpr size_t WS_WGU = 16 * MiB, WS_WD = 360 * MiB, WS_WAB = 532 * MiB, WS_WIN = 564 * MiB, WS_WOUT = 612 * MiB, WS_GW = 628 * MiB;
constexpr size_t WS_AP = 629 * MiB, WS_BB = 632 * MiB, WS_T0 = 636 * MiB, WS_WM = 668 * MiB, WS_FM = 684 * MiB;
constexpr size_t WS_X = 704 * MiB, WS_Y = 770 * MiB, WS_XN = 836 * MiB, WS_Z = 869 * MiB, WS_H = 902 * MiB, WS_HH = 1002 * MiB, WS_E = 1068 * MiB, WS_HIN = 1101 * MiB, WS_GT = 1118 * MiB, WS_END = 1120 * MiB;
constexpr int CW_BAR = 4096;
constexpr int RING_BYTES = 131072, LDSCTL_OFF = RING_BYTES, MISC_OFF = LDSCTL_OFF + 320, LDS_BYTES = 147456;

#define LDS_WAIT() asm volatile("s_waitcnt lgkmcnt(0)" ::: "memory")
__device__ __forceinline__ unsigned f2bf(float f) { unsigned u = __builtin_bit_cast(unsigned, f); return (u + 0x7fffu + ((u >> 16) & 1u)) >> 16; }
__device__ __forceinline__ unsigned pk2(float lo, float hi) { return f2bf(lo) | (f2bf(hi) << 16); }
__device__ __forceinline__ float bf2f(unsigned short b) { return __builtin_bit_cast(float, ((unsigned)b) << 16); }
__device__ __forceinline__ float bflo(unsigned w) { return __builtin_bit_cast(float, w << 16); }
__device__ __forceinline__ float bfhi(unsigned w) { return __builtin_bit_cast(float, w & 0xffff0000u); }
__device__ __forceinline__ float wave_sum(float v) {
#pragma unroll
    for (int o = 1; o < 64; o <<= 1) v += __shfl_xor(v, o);
    return v;
}
__device__ __forceinline__ float sigmoidf_(float x) { return 1.0f / (1.0f + __expf(-x)); }
__device__ __forceinline__ float gelu_tanh(float x) { const float u = 0.7978845608028654f * (x + 0.044715f * x * x * x); const float e = __expf(2.0f * u); const float t = 1.0f - 2.0f / (e + 1.0f); return 0.5f * x * (1.0f + t); }
__device__ __forceinline__ void sincos_small(float x, float& s, float& c) {
    const float kf = rintf(x * 0.6366197723675814f); const int k = (int)kf;
    float r = fmaf(-kf, 1.57079637050628662109375f, x); r = fmaf(-kf, -4.37113900018624283e-8f, r);
    const float r2 = r * r;
    const float sp = r + r * r2 * (-1.6666654611e-1f + r2 * (8.3321608736e-3f + r2 * (-1.9515295891e-4f)));
    const float cp = 1.0f - 0.5f * r2 + r2 * r2 * (4.166664568298827e-2f + r2 * (-1.388731625493765e-3f + r2 * (2.443315711809948e-5f)));
    switch (k & 3) { case 0: s = sp; c = cp; break; case 1: s = cp; c = -sp; break; case 2: s = -sp; c = -cp; break; default: s = -cp; c = sp; break; }
}
__device__ __forceinline__ f32x4 mfma16(bf16x8 a, bf16x8 b, f32x4 c) { return __builtin_amdgcn_mfma_f32_16x16x32_bf16(a, b, c, 0, 0, 0); }

struct Frame {
    LAS unsigned char* lds;
    int tid, lane, wave, G, gw, NGW;
    const float* const __attribute__((address_space(4)))* in; float* out; unsigned char* ws;
};
struct Args { const float* in[27]; float* out; unsigned char* ws; int seg_lo, seg_hi, one, pad; };
enum { I_XP = 0, I_XS, I_S5RE, I_S5IM, I_MLC, I_MLN, I_MLM, I_LNG, I_LNB, I_WG, I_WU, I_WD, I_AR, I_AI, I_LDT, I_BR, I_BI, I_CR, I_CI, I_S5D, I_WA, I_WB, I_WIN, I_BIg, I_BFg, I_NG, I_WOUT };

__device__ __forceinline__ void transpose_item(const float* W, size_t ldw, int K, bf16* WT, int n0, int k0, int drow0, float scale, LAS float* scr, int lane) {
#pragma unroll 8
    for (int i = 0; i < 32; ++i) { const int kk = 2 * i + (lane >> 5); scr[kk * 33 + (lane & 31)] = W[(size_t)(k0 + kk) * ldw + n0 + (lane & 31)]; }
    LDS_WAIT(); asm volatile("" ::: "memory");
    const int c = lane & 7;
#pragma unroll
    for (int j = 0; j < 4; ++j) { const int n = (lane >> 3) + 8 * j; const LAS float* s = scr + (8 * c) * 33 + n;
        v4u o; o.x = pk2(s[0 * 33] * scale, s[1 * 33] * scale); o.y = pk2(s[2 * 33] * scale, s[3 * 33] * scale); o.z = pk2(s[4 * 33] * scale, s[5 * 33] * scale); o.w = pk2(s[6 * 33] * scale, s[7 * 33] * scale);
        *(GAS v4u*)(WT + (size_t)(drow0 + n) * K + k0 + 8 * c) = o; }
    LDS_WAIT(); asm volatile("" ::: "memory");
}
__device__ __forceinline__ void p0a(Frame& F) {
    LAS float* scr = (LAS float*)(F.lds + F.wave * 16384);
    const int lane = F.lane;
    constexpr int NFF = 44032, NIT = 3 * NFF + 4096 + 4096 + 12288 + 4096;
    for (int it = F.gw; it < NIT; it += F.NGW) {
        int r = it;
        if (r < 3 * NFF) { const int seg = r / NFF; r -= seg * NFF; const int mat = r / 5504, q = r % 5504;
            if (seg < 2) { const int nb = q % 172, kb = q / 172, n0 = nb * 32;
                transpose_item(F.in[I_WG + seg] + (size_t)mat * D * DFF, DFF, D, (bf16*)(F.ws + WS_WGU) + (size_t)mat * 2 * DFF * D, n0, kb * 64, (n0 >> 7) * 256 + seg * 128 + (n0 & 127), 1.0f, scr, lane); }
            else { const int nb = q % 64, kb = q / 64;
                transpose_item(F.in[I_WD] + (size_t)mat * DFF * D, D, DFF, (bf16*)(F.ws + WS_WD) + (size_t)mat * D * DFF, nb * 32, kb * 64, nb * 32, 1.0f, scr, lane); }
            continue; }
        r -= 3 * NFF;
        if (r < 8192) { const int seg = r >> 12; r &= 4095; const int mat = r >> 11, q = r & 2047, nb = q & 63, kb = q >> 6, n0 = nb * 32;
            transpose_item(F.in[I_WA + seg] + (size_t)mat * D * D, D, D, (bf16*)(F.ws + WS_WAB) + (size_t)mat * 2 * D * D, n0, kb * 64, (n0 >> 7) * 256 + seg * 128 + (n0 & 127), 1.0f, scr, lane);
            continue; }
        r -= 8192;
        if (r < 12288) { const int mat = r / 6144, q = r % 6144, nb = q % 192, kb = q / 192, n0 = nb * 32;
            transpose_item(F.in[I_WIN] + (size_t)mat * D * NPROJ, NPROJ, D, (bf16*)(F.ws + WS_WIN) + (size_t)mat * NPM * D, n0, kb * 64, n0, (n0 >= 1024 && n0 < 2048) ? 0.0625f : 1.0f, scr, lane);
            continue; }
        r -= 12288;
        { const int mat = r >> 11, q = r & 2047, nb = q & 63, kb = q >> 6;
            transpose_item(F.in[I_WOUT] + (size_t)mat * D * D, D, D, (bf16*)(F.ws + WS_WOUT) + (size_t)mat * D * D, nb * 32, kb * 64, nb * 32, 1.0f, scr, lane); }
    }
    float* X = (float*)(F.ws + WS_X); bf16* XN = (bf16*)(F.ws + WS_XN); bf16* Z = (bf16*)(F.ws + WS_Z);
    for (int m = F.gw; m < MP; m += F.NGW) {
        GAS f32x4* xo = (GAS f32x4*)(X + (size_t)m * D) + lane; GAS v2u* no = (GAS v2u*)(XN + (size_t)m * D) + lane;
        if (m < MTOK) { const float* src = (m < MPROMPT) ? F.in[I_XP] + (size_t)m * D : F.in[I_XS] + (size_t)(m - MPROMPT) * D; const GAS f32x4* xi = (const GAS f32x4*)src + lane;
#pragma unroll
            for (int j = 0; j < 8; ++j) { const f32x4 v = xi[64 * j]; xo[64 * j] = v; v2u w; w.x = pk2(v.x, v.y); w.y = pk2(v.z, v.w); no[64 * j] = w; } }
        else { GAS v2u* zo = (GAS v2u*)(Z + (size_t)m * D) + lane;
#pragma unroll
            for (int j = 0; j < 8; ++j) { xo[64 * j] = (f32x4){0.f, 0.f, 0.f, 0.f}; no[64 * j] = (v2u){0u, 0u}; zo[64 * j] = (v2u){0u, 0u}; } }
    }
    { float* GW = (float*)(F.ws + WS_GW); const int gt = F.gw * 64 + lane, NT = F.NGW * 64;
      for (int i = gt; i < 2 * D * 8; i += NT) { const int jj = i / (D * 8), rem = i % (D * 8), k = rem >> 3, c = rem & 7; GW[i] = F.in[I_WIN][((size_t)jj * D + k) * NPROJ + NPM + c]; }
      f32x2* AP = (f32x2*)(F.ws + WS_AP); f32x2* BB = (f32x2*)(F.ws + WS_BB);
      for (int i = gt; i < 2 * S5G * S5P; i += NT) { const int p = i & 63, jg = i >> 6;
          const float ar = F.in[I_AR][i], ai = F.in[I_AI][i]; const float dt = expf(F.in[I_LDT][jg]);
          const float mag = expf(dt * ar); float sn, cs; sincos_small(dt * ai, sn, cs);
          const float abr = mag * cs, abi = mag * sn, zr = abr - 1.0f, zi = abi, den = ar * ar + ai * ai;
          const float gr = (zr * ar + zi * ai) / den, gi = (zi * ar - zr * ai) / den;
          float pr = 1.0f, pi = 0.0f;
          for (int lag = 0; lag <= 16; ++lag) { AP[((size_t)jg * 17 + lag) * 64 + p] = (f32x2){pr, pi}; const float nr = pr * abr - pi * abi, ni = pr * abi + pi * abr; pr = nr; pi = ni; }
          const float* br = F.in[I_BR] + (size_t)i * 16; const float* bi = F.in[I_BI] + (size_t)i * 16;
#pragma unroll
          for (int c = 0; c < 16; ++c) BB[(size_t)i * 16 + c] = (f32x2){gr * br[c] - gi * bi[c], gr * bi[c] + gi * br[c]}; }
    }
}
__device__ __forceinline__ void p0b(Frame& F) {
    LAS f32x2* sAP = (LAS f32x2*)F.lds;
    LAS f32x2* sBB = sAP + 17 * 64;
    LAS f32x2* sC = sBB + 64 * 16;
    const f32x2* AP = (const f32x2*)(F.ws + WS_AP); const f32x2* BB = (const f32x2*)(F.ws + WS_BB);
    for (int jg = blockIdx.x; jg < 2 * S5G; jg += F.G) {
        __syncthreads();
        for (int i = F.tid; i < 17 * 64; i += 512) sAP[i] = AP[(size_t)jg * 17 * 64 + i];
        for (int i = F.tid; i < 1024; i += 512) { sBB[i] = BB[(size_t)jg * 1024 + i]; sC[i] = (f32x2){F.in[I_CR][(size_t)jg * 1024 + i], F.in[I_CI][(size_t)jg * 1024 + i]}; }
        __syncthreads();
        bf16* T0 = (bf16*)(F.ws + WS_T0) + (size_t)jg * 65536; bf16* WM = (bf16*)(F.ws + WS_WM) + (size_t)jg * 32768; bf16* FM = (bf16*)(F.ws + WS_FM) + (size_t)jg * 32768;
        for (int e = F.tid; e < 4096; e += 512) { const int lag = e >> 8, co = (e >> 4) & 15, ci = e & 15; float acc = 0.f;
            for (int p = 0; p < 64; ++p) { const f32x2 c = sC[co * 64 + p], a = sAP[lag * 64 + p], b = sBB[p * 16 + ci];
                const float xr = c.x * a.x - c.y * a.y, xi = c.x * a.y + c.y * a.x; acc += xr * b.x - xi * b.y; }
            const bf16 v = (bf16)f2bf(acc);
            for (int s = 0; s + lag < 16; ++s) { T0[(size_t)((s + lag) * 16 + co) * 256 + s * 16 + ci] = v; if (lag) T0[(size_t)(s * 16 + co) * 256 + (s + lag) * 16 + ci] = 0; } }
        for (int e = F.tid; e < 32768; e += 512) { const int pp = e >> 8, k = e & 255, s = k >> 4, ci = k & 15, p = pp & 63;
            const f32x2 a = sAP[(15 - s) * 64 + p], b = sBB[p * 16 + ci]; const float wr = a.x * b.x - a.y * b.y, wi = a.x * b.y + a.y * b.x;
            WM[e] = (bf16)f2bf(pp < 64 ? wr : wi); }
        for (int e = F.tid; e < 32768; e += 512) { const int n = e >> 7, pp = e & 127, t = n >> 4, co = n & 15, p = pp & 63;
            const f32x2 c = sC[co * 64 + p], a = sAP[(t + 1) * 64 + p]; const float xr = c.x * a.x - c.y * a.y, xi = c.x * a.y + c.y * a.x;
            FM[e] = (bf16)f2bf(pp < 64 ? xr : -xi); }
    }
}

template <bool GATES, bool FINAL> __device__ __forceinline__ void ln_phase(Frame& F, int lnidx, int jml) {
    const float* Y = (const float*)(F.ws + WS_Y); float* X = (float*)(F.ws + WS_X); bf16* XN = (bf16*)(F.ws + WS_XN);
    const float* lg = F.in[I_LNG] + (size_t)lnidx * D; const float* lb = F.in[I_LNB] + (size_t)lnidx * D; const int lane = F.lane;
    for (int m = F.gw; m < MTOK; m += F.NGW) {
        const GAS f32x4* yr = (const GAS f32x4*)(Y + (size_t)m * D) + lane;
        f32x4 v[8]; float s = 0.f;
#pragma unroll
        for (int j = 0; j < 8; ++j) { v[j] = yr[64 * j]; s += (v[j].x + v[j].y) + (v[j].z + v[j].w); }
        const float mean = wave_sum(s) * (1.f / D); float s2 = 0.f;
#pragma unroll
        for (int j = 0; j < 8; ++j) { v[j] = v[j] - mean; s2 += (v[j].x * v[j].x + v[j].y * v[j].y) + (v[j].z * v[j].z + v[j].w * v[j].w); }
        const float rstd = 1.f / sqrtf(wave_sum(s2) * (1.f / D) + LN_EPS);
        float* dst = FINAL ? (m < MPROMPT ? F.out + O_YP + (size_t)m * D : F.out + O_YS + (size_t)(m - MPROMPT) * D) : X + (size_t)m * D;
        GAS f32x4* xo = (GAS f32x4*)dst + lane; GAS v2u* no = (GAS v2u*)(XN + (size_t)m * D) + lane;
#pragma unroll
        for (int j = 0; j < 8; ++j) { const f32x4 g = ((const GAS f32x4*)lg)[lane + 64 * j], b = ((const GAS f32x4*)lb)[lane + 64 * j];
            v[j] = v[j] * rstd * g + b; xo[64 * j] = v[j]; if (!FINAL) { v2u w; w.x = pk2(v[j].x, v[j].y); w.y = pk2(v[j].z, v[j].w); no[64 * j] = w; } }
        if (GATES) { const float* GW = (const float*)(F.ws + WS_GW) + (size_t)jml * D * 8; float a[8];
#pragma unroll
            for (int c = 0; c < 8; ++c) a[c] = 0.f;
#pragma unroll
            for (int j = 0; j < 8; ++j)
#pragma unroll
                for (int e = 0; e < 4; ++e) { const int k = 4 * lane + e + 256 * j; const f32x4 w0 = *(const GAS f32x4*)(GW + (size_t)k * 8), w1 = *(const GAS f32x4*)(GW + (size_t)k * 8 + 4); const float xv = v[j][e];
                    a[0] += xv * w0.x; a[1] += xv * w0.y; a[2] += xv * w0.z; a[3] += xv * w0.w; a[4] += xv * w1.x; a[5] += xv * w1.y; a[6] += xv * w1.z; a[7] += xv * w1.w; }
#pragma unroll
            for (int c = 0; c < 8; ++c) a[c] = wave_sum(a[c]);
            if (lane == 0) { float* gt = (float*)(F.ws + WS_GT) + (size_t)m * 8;
#pragma unroll
                for (int hh = 0; hh < 4; ++hh) { gt[hh] = a[hh] + F.in[I_BIg][jml * 4 + hh]; const float f = a[4 + hh] + F.in[I_BFg][jml * 4 + hh]; gt[4 + hh] = fminf(f, 0.f) - log1pf(expf(-fabsf(f))); } }
        }
    }
}

__device__ __forceinline__ bf16x8 s5_afrag(const bf16* XN, int sb, int g, int kk, int q) { return *(const GAS bf16x8*)(XN + (size_t)(16 * sb + 2 * kk + (q >> 1)) * D + 16 * g + 8 * (q & 1)); }
__device__ __forceinline__ void s5a(Frame& F, int j) {
    const bf16* XN = (const bf16*)(F.ws + WS_XN); const float* X = (const float*)(F.ws + WS_X); float* E = (float*)(F.ws + WS_E); bf16* Z = (bf16*)(F.ws + WS_Z);
    const int lane = F.lane, r = lane & 15, q = lane >> 4;
    for (int it = F.gw; it < 32 * S5G; it += F.NGW) { const int mt = it >> 7, g = it & 127;
        const bf16* WM = (const bf16*)(F.ws + WS_WM) + (size_t)(j * S5G + g) * 32768;
        f32x4 acc[8];
#pragma unroll
        for (int n = 0; n < 8; ++n) acc[n] = (f32x4){0.f, 0.f, 0.f, 0.f};
#pragma unroll
        for (int kk = 0; kk < 8; ++kk) { const bf16x8 a = s5_afrag(XN, 16 * mt + r, g, kk, q);
#pragma unroll
            for (int n = 0; n < 8; ++n) { const bf16x8 b = *(const GAS bf16x8*)(WM + (size_t)(16 * n + r) * 256 + 32 * kk + 8 * q); acc[n] = mfma16(a, b, acc[n]); } }
#pragma unroll
        for (int n = 0; n < 8; ++n)
#pragma unroll
            for (int i = 0; i < 4; ++i) E[((size_t)(16 * mt + 4 * q + i) * S5G + g) * 128 + 16 * n + r] = acc[n][i];
    }
    const f32x2* AP = (const f32x2*)(F.ws + WS_AP); const f32x2* BB = (const f32x2*)(F.ws + WS_BB);
    for (int it = F.gw; it < NDEC * S5G; it += F.NGW) { const int d = it >> 7, g = it & 127, jg = j * S5G + g, p = lane;
        const float* xr = X + (size_t)(MPROMPT + d) * D + 16 * g; float u[16];
#pragma unroll
        for (int c = 0; c < 4; ++c) { const f32x4 t = *(const GAS f32x4*)(xr + 4 * c); u[4 * c] = t.x; u[4 * c + 1] = t.y; u[4 * c + 2] = t.z; u[4 * c + 3] = t.w; }
        const f32x2 ab = AP[((size_t)jg * 17 + 1) * 64 + p];
        const size_t si = (((size_t)j * NDEC + d) * S5G + g) * S5P + p; const float h0r = F.in[I_S5RE][si], h0i = F.in[I_S5IM][si];
        float hr = ab.x * h0r - ab.y * h0i, hi = ab.x * h0i + ab.y * h0r;
#pragma unroll
        for (int c = 0; c < 16; ++c) { const f32x2 b = BB[((size_t)jg * 64 + p) * 16 + c]; hr += b.x * u[c]; hi += b.y * u[c]; }
        F.out[O_SS5R + si] = hr; F.out[O_SS5I + si] = hi;
        float yv = 0.f;
#pragma unroll
        for (int co = 0; co < 16; ++co) { const float cr = F.in[I_CR][((size_t)jg * 16 + co) * 64 + p], ci = F.in[I_CI][((size_t)jg * 16 + co) * 64 + p];
            const float t = wave_sum(cr * hr - ci * hi); if (lane == co) yv = t; }
        if (lane < 16) { const float y = yv + F.in[I_S5D][(size_t)j * D + 16 * g + lane] * xr[lane]; Z[(size_t)(MPROMPT + d) * D + 16 * g + lane] = (bf16)f2bf(gelu_tanh(y)); }
    }
}
__device__ __forceinline__ void s5b(Frame& F, int j) {
    const float* E = (const float*)(F.ws + WS_E); bf16* HIN = (bf16*)(F.ws + WS_HIN); const f32x2* AP = (const f32x2*)(F.ws + WS_AP); const int p = F.lane;
    for (int it = blockIdx.x + F.G * F.wave; it < NB * S5G; it += F.G * NWAVES) { const int b = it >> 7, g = it & 127, jg = j * S5G + g;
        const f32x2 a16 = AP[((size_t)jg * 17 + 16) * 64 + p]; float hr = 0.f, hi = 0.f;
        for (int n0 = 0; n0 < 128; n0 += 8) { float er[8], ei[8];
#pragma unroll
            for (int u = 0; u < 8; ++u) { const size_t o = ((size_t)(b * 128 + n0 + u) * S5G + g) * 128; er[u] = E[o + p]; ei[u] = E[o + 64 + p]; }
#pragma unroll
            for (int u = 0; u < 8; ++u) { const size_t o = ((size_t)(b * 128 + n0 + u) * S5G + g) * 128; HIN[o + p] = (bf16)f2bf(hr); HIN[o + 64 + p] = (bf16)f2bf(hi);
                const float nr = a16.x * hr - a16.y * hi + er[u], ni = a16.x * hi + a16.y * hr + ei[u]; hr = nr; hi = ni; } }
        const size_t so = (((size_t)j * NB + b) * S5G + g) * S5P + p; F.out[O_PS5R + so] = hr; F.out[O_PS5I + so] = hi;
    }
}
__device__ __forceinline__ void s5c(Frame& F, int j) {
    const bf16* XN = (const bf16*)(F.ws + WS_XN); const float* X = (const float*)(F.ws + WS_X); const bf16* HIN = (const bf16*)(F.ws + WS_HIN); bf16* Z = (bf16*)(F.ws + WS_Z);
    const int lane = F.lane, r = lane & 15, q = lane >> 4;
    for (int it = F.gw; it < 16 * S5G; it += F.NGW) { const int mtp = it >> 7, g = it & 127;
        const bf16* T0 = (const bf16*)(F.ws + WS_T0) + (size_t)(j * S5G + g) * 65536; const bf16* FM = (const bf16*)(F.ws + WS_FM) + (size_t)(j * S5G + g) * 32768;
        f32x4 acc[2][16];
#pragma unroll
        for (int ms = 0; ms < 2; ++ms)
#pragma unroll
            for (int n = 0; n < 16; ++n) acc[ms][n] = (f32x4){0.f, 0.f, 0.f, 0.f};
#pragma unroll 2
        for (int kk = 0; kk < 8; ++kk) { const bf16x8 a0 = s5_afrag(XN, 32 * mtp + r, g, kk, q), a1 = s5_afrag(XN, 32 * mtp + 16 + r, g, kk, q);
#pragma unroll
            for (int n = 0; n < 16; ++n) { const bf16x8 b = *(const GAS bf16x8*)(T0 + (size_t)(16 * n + r) * 256 + 32 * kk + 8 * q); acc[0][n] = mfma16(a0, b, acc[0][n]); acc[1][n] = mfma16(a1, b, acc[1][n]); } }
#pragma unroll 2
        for (int kk = 0; kk < 4; ++kk) { const bf16x8 a0 = *(const GAS bf16x8*)(HIN + ((size_t)(32 * mtp + r) * S5G + g) * 128 + 32 * kk + 8 * q), a1 = *(const GAS bf16x8*)(HIN + ((size_t)(32 * mtp + 16 + r) * S5G + g) * 128 + 32 * kk + 8 * q);
#pragma unroll
            for (int n = 0; n < 16; ++n) { const bf16x8 b = *(const GAS bf16x8*)(FM + (size_t)(16 * n + r) * 128 + 32 * kk + 8 * q); acc[0][n] = mfma16(a0, b, acc[0][n]); acc[1][n] = mfma16(a1, b, acc[1][n]); } }
        const float dsk = F.in[I_S5D][(size_t)j * D + 16 * g + r];
#pragma unroll
        for (int ms = 0; ms < 2; ++ms)
#pragma unroll
            for (int n = 0; n < 16; ++n)
#pragma unroll
                for (int i = 0; i < 4; ++i) { const size_t o = (size_t)(16 * (32 * mtp + 16 * ms + 4 * q + i) + n) * D + 16 * g + r; const float y = acc[ms][n][i] + dsk * X[o]; Z[o] = (bf16)f2bf(gelu_tanh(y)); }
    }
}

constexpr int KT_LD = 136, CT_LD = 264;
__device__ __forceinline__ void mlstm_prompt_unit(Frame& F, int j, int b, int h, int vs) {
    LAS unsigned char* L = F.lds;
    LAS bf16* KT = (LAS bf16*)(L + 0);
    LAS bf16* Pm = KT;
    LAS bf16* VT = (LAS bf16*)(L + 69632);
    LAS bf16* VdT = (LAS bf16*)(L + 82688);
    LAS bf16* CT = (LAS bf16*)(L + 95744);
    LAS float* sA = (LAS float*)(L + 121088);
    LAS float* sBT = sA + 128;
    LAS float* sSC = sBT + 128;
    LAS float* sEM = sSC + 128;
    LAS float* sDEC = sEM + 128;
    LAS float* sMS = sDEC + 128;
    const bf16* QK = (const bf16*)(F.ws + WS_H); const float* GT = (const float*)(F.ws + WS_GT); float* HH = (float*)(F.ws + WS_HH);
    const int tid = F.tid, lane = F.lane, w = F.wave, r = lane & 15, q = lane >> 4;
    __syncthreads();
    for (int i = tid; i < 48 * KT_LD; i += 512) { VT[i] = 0; VdT[i] = 0; }
    for (int i = tid; i < 48 * CT_LD; i += 512) CT[i] = 0;
    f32x4 Cacc[3][2];
#pragma unroll
    for (int mt = 0; mt < 3; ++mt)
#pragma unroll
        for (int nn = 0; nn < 2; ++nn) Cacc[mt][nn] = (f32x4){0.f, 0.f, 0.f, 0.f};
    float mrun = 0.f;
    for (int c = 0; c < 16; ++c) {
        const size_t row0 = (size_t)b * SEQ + 128 * c;
        __syncthreads();
        if (w == 0) {
            const float ig0 = GT[(row0 + 2 * lane) * 8 + h], ig1 = GT[(row0 + 2 * lane + 1) * 8 + h], lf0 = GT[(row0 + 2 * lane) * 8 + 4 + h], lf1 = GT[(row0 + 2 * lane + 1) * 8 + 4 + h];
            float cs = lf0 + lf1;
#pragma unroll
            for (int o = 1; o < 64; o <<= 1) { const float t = __shfl_up(cs, o); if (lane >= o) cs += t; }
            const float b1 = cs, b0 = cs - lf1, a0 = ig0 - b0, a1 = ig1 - b1;
            float pm = fmaxf(a0, a1);
#pragma unroll
            for (int o = 1; o < 64; o <<= 1) { const float t = __shfl_up(pm, o); if (lane >= o) pm = fmaxf(pm, t); }
            float pme = __shfl_up(pm, 1); if (lane == 0) pme = -3.0e38f;
            const float pm0 = fmaxf(pme, a0), pm1 = pm;
            const float total = __shfl(b1, 63), pml = __shfl(pm1, 63);
            const float mx0 = fmaxf(mrun, pm0), mx1 = fmaxf(mrun, pm1);
            const float mlast = total + fmaxf(mrun, pml);
            sA[2 * lane] = a0; sA[2 * lane + 1] = a1; sBT[2 * lane] = -mx0; sBT[2 * lane + 1] = -mx1;
            sSC[2 * lane] = __expf(mrun - mx0); sSC[2 * lane + 1] = __expf(mrun - mx1);
            sEM[2 * lane] = __expf(-(b0 + mx0)); sEM[2 * lane + 1] = __expf(-(b1 + mx1));
            sDEC[2 * lane] = __expf(a0 + total - mlast); sDEC[2 * lane + 1] = __expf(a1 + total - mlast);
            if (lane == 0) { sMS[0] = __expf(total + mrun - mlast); sMS[1] = mlast; }
        }
        __syncthreads();
        const float cscale = sMS[0]; mrun = sMS[1];
        {
            const int s = tid & 127, vc = tid >> 7; const float dec = sDEC[s];
            const v4u raw = *(const GAS v4u*)(QK + (row0 + s) * NPM + 2048 + h * 512 + vs * 32 + 8 * vc);
            const unsigned ww[4] = {raw.x, raw.y, raw.z, raw.w};
#pragma unroll
            for (int e = 0; e < 4; ++e) { VT[(8 * vc + 2 * e) * KT_LD + s] = (bf16)(ww[e] & 0xffffu); VT[(8 * vc + 2 * e + 1) * KT_LD + s] = (bf16)(ww[e] >> 16);
                VdT[(8 * vc + 2 * e) * KT_LD + s] = (bf16)f2bf(bflo(ww[e]) * dec); VdT[(8 * vc + 2 * e + 1) * KT_LD + s] = (bf16)f2bf(bfhi(ww[e]) * dec); }
            if (vc == 0) { VT[32 * KT_LD + s] = 0x3f80; VdT[32 * KT_LD + s] = (bf16)f2bf(dec); }
        }
        bf16x8 aq[8];
#pragma unroll
        for (int kk = 0; kk < 8; ++kk) aq[kk] = *(const GAS bf16x8*)(QK + (row0 + 16 * w + r) * NPM + h * 256 + 32 * kk + 8 * q);
        for (int nt = 0; nt <= w; ++nt) { f32x4 s4 = (f32x4){0.f, 0.f, 0.f, 0.f};
#pragma unroll
            for (int kk = 0; kk < 8; ++kk) { const bf16x8 bk = *(const GAS bf16x8*)(QK + (row0 + 16 * nt + r) * NPM + 1024 + h * 256 + 32 * kk + 8 * q); s4 = mfma16(aq[kk], bk, s4); }
            const float as = sA[16 * nt + r];
#pragma unroll
            for (int i = 0; i < 4; ++i) { const int t = 16 * w + 4 * q + i, s = 16 * nt + r; const float val = (s <= t) ? s4[i] * __expf(sBT[t] + as) : 0.f; Pm[t * KT_LD + s] = (bf16)f2bf(val); } }
        if (!(w & 1)) {
#pragma unroll
            for (int i = 0; i < 4; ++i) Pm[(16 * w + 4 * q + i) * KT_LD + 16 * (w + 1) + r] = 0; }
        __syncthreads();
        f32x4 a1[3], a2[3];
#pragma unroll
        for (int n = 0; n < 3; ++n) { a1[n] = (f32x4){0.f, 0.f, 0.f, 0.f}; a2[n] = (f32x4){0.f, 0.f, 0.f, 0.f}; }
        for (int kk = 0; kk <= (w >> 1); ++kk) { const bf16x8 ap = *(const LAS bf16x8*)(Pm + (16 * w + r) * KT_LD + 32 * kk + 8 * q);
#pragma unroll
            for (int n = 0; n < 3; ++n) { const bf16x8 bv = *(const LAS bf16x8*)(VT + (16 * n + r) * KT_LD + 32 * kk + 8 * q); a1[n] = mfma16(ap, bv, a1[n]); } }
#pragma unroll
        for (int kk = 0; kk < 8; ++kk) {
#pragma unroll
            for (int n = 0; n < 3; ++n) { const bf16x8 bc = *(const LAS bf16x8*)(CT + (16 * n + r) * CT_LD + 32 * kk + 8 * q); a2[n] = mfma16(aq[kk], bc, a2[n]); } }
#pragma unroll
        for (int i = 0; i < 4; ++i) { const int t = 16 * w + 4 * q + i; const float sc = sSC[t];
            const float den = __shfl(sc * a2[2][i] + a1[2][i], lane & 48); const float dd = fmaxf(fabsf(den), sEM[t]); const float inv = 1.0f / dd;
            float* hp = HH + (row0 + t) * D + h * 512 + vs * 32 + r;
            hp[0] = (sc * a2[0][i] + a1[0][i]) * inv; hp[16] = (sc * a2[1][i] + a1[1][i]) * inv; }
        __syncthreads();
#pragma unroll 2
        for (int itr = 0; itr < 8; ++itr) { const int e = tid + 512 * itr, s = e & 127, dc = e >> 7;
            const v4u raw = *(const GAS v4u*)(QK + (row0 + s) * NPM + 1024 + h * 256 + 8 * dc); const unsigned ww[4] = {raw.x, raw.y, raw.z, raw.w};
#pragma unroll
            for (int e2 = 0; e2 < 4; ++e2) { KT[(8 * dc + 2 * e2) * KT_LD + s] = (bf16)(ww[e2] & 0xffffu); KT[(8 * dc + 2 * e2 + 1) * KT_LD + s] = (bf16)(ww[e2] >> 16); } }
        __syncthreads();
#pragma unroll
        for (int mt = 0; mt < 3; ++mt)
#pragma unroll
            for (int nn = 0; nn < 2; ++nn) Cacc[mt][nn] = Cacc[mt][nn] * cscale;
#pragma unroll
        for (int kk = 0; kk < 4; ++kk) { bf16x8 bk[2];
#pragma unroll
            for (int nn = 0; nn < 2; ++nn) bk[nn] = *(const LAS bf16x8*)(KT + (16 * (2 * w + nn) + r) * KT_LD + 32 * kk + 8 * q);
#pragma unroll
            for (int mt = 0; mt < 3; ++mt) { const bf16x8 av = *(const LAS bf16x8*)(VdT + (16 * mt + r) * KT_LD + 32 * kk + 8 * q);
#pragma unroll
                for (int nn = 0; nn < 2; ++nn) Cacc[mt][nn] = mfma16(av, bk[nn], Cacc[mt][nn]); } }
#pragma unroll
        for (int mt = 0; mt < 3; ++mt)
#pragma unroll
            for (int nn = 0; nn < 2; ++nn)
#pragma unroll
                for (int i = 0; i < 4; ++i) CT[(16 * mt + 4 * q + i) * CT_LD + 16 * (2 * w + nn) + r] = (bf16)f2bf(Cacc[mt][nn][i]);
    }
    const size_t sb = ((size_t)j * NB + b) * NH + h;
#pragma unroll
    for (int mt = 0; mt < 2; ++mt)
#pragma unroll
        for (int nn = 0; nn < 2; ++nn)
#pragma unroll
            for (int i = 0; i < 4; ++i) F.out[O_PC + (sb * DK + 16 * (2 * w + nn) + r) * DV + vs * 32 + 16 * mt + 4 * q + i] = Cacc[mt][nn][i];
    if (vs == 0) { if (q == 0) {
#pragma unroll
            for (int nn = 0; nn < 2; ++nn) F.out[O_PN + sb * DK + 16 * (2 * w + nn) + r] = Cacc[2][nn][0]; }
        if (tid == 0) F.out[O_PM + sb] = mrun; }
}
__device__ __forceinline__ void mlstm_sample_unit(Frame& F, int j, int d, int h) {
    LAS float* sQ = (LAS float*)F.lds; LAS float* sK = sQ + 256; LAS float* sR = sK + 256;
    LAS f32x4* sRed = (LAS f32x4*)(sR + 16);
    const bf16* QK = (const bf16*)(F.ws + WS_H); const float* GT = (const float*)(F.ws + WS_GT); float* HH = (float*)(F.ws + WS_HH);
    const int tid = F.tid, lane = F.lane, w = F.wave; const size_t row = MPROMPT + d; const size_t sb = ((size_t)j * NDEC + d) * NH + h;
    __syncthreads();
    float qv = 0.f, kv = 0.f, nv = 0.f;
    if (tid < 256) { qv = bf2f(QK[row * NPM + h * 256 + tid]); kv = bf2f(QK[row * NPM + 1024 + h * 256 + tid]); nv = F.in[I_MLN][sb * DK + tid]; sQ[tid] = qv; sK[tid] = kv; }
    const float pqk = wave_sum(qv * kv), pqn = wave_sum(qv * nv);
    if (lane == 0) { sR[w] = pqk; sR[8 + w] = pqn; }
    __syncthreads();
    const float qk = (sR[0] + sR[1]) + (sR[2] + sR[3]), qn = (sR[8] + sR[9]) + (sR[10] + sR[11]);
    const float ig = GT[row * 8 + h], lf = GT[row * 8 + 4 + h], m0 = F.in[I_MLM][sb];
    const float mt = fmaxf(lf + m0, ig), scale = __expf(lf + m0 - mt), dec = __expf(ig - mt);
    const int dv4 = tid & 127, rg = tid >> 7;
    const v2u vraw = *(const GAS v2u*)(QK + row * NPM + 2048 + h * 512 + 4 * dv4);
    const f32x4 v4 = (f32x4){bflo(vraw.x), bfhi(vraw.x), bflo(vraw.y), bfhi(vraw.y)};
    const GAS f32x4* C0 = (const GAS f32x4*)(F.in[I_MLC] + sb * DK * DV) + dv4; GAS f32x4* CN = (GAS f32x4*)(F.out + O_SC + sb * DK * DV) + dv4;
    f32x4 acc = (f32x4){0.f, 0.f, 0.f, 0.f};
#pragma unroll 8
    for (int i = 0; i < 64; ++i) { const int dk = rg * 64 + i; const f32x4 c4 = C0[(size_t)dk * 128]; acc += c4 * sQ[dk]; CN[(size_t)dk * 128] = c4 * scale + v4 * (dec * sK[dk]); }
    sRed[rg * 128 + dv4] = acc;
    __syncthreads();
    if (tid < 128) { const f32x4 qc = (sRed[tid] + sRed[128 + tid]) + (sRed[256 + tid] + sRed[384 + tid]); const float sc = qk * dec, den = scale * qn + sc, dd = fmaxf(fabsf(den), __expf(-mt));
        *(GAS f32x4*)(HH + row * D + h * 512 + 4 * tid) = (qc * scale + v4 * sc) * (1.0f / dd); }
    if (tid < 256) F.out[O_SN + sb * DK + tid] = scale * nv + dec * kv;
    if (tid == 0) F.out[O_SM + sb] = mt;
}
__device__ __forceinline__ void mlstm_rec(Frame& F, int j) {
    for (int u = blockIdx.x; u < 256; u += F.G) mlstm_prompt_unit(F, j, u >> 6, (u >> 4) & 3, u & 15);
    for (int u = blockIdx.x; u < NDEC * NH; u += F.G) mlstm_sample_unit(F, j, u >> 2, u & 3);
}
__device__ __forceinline__ void mlstm_headnorm(Frame& F, int j) {
    const float* HH = (const float*)(F.ws + WS_HH); const bf16* QK = (const bf16*)(F.ws + WS_H); bf16* Z = (bf16*)(F.ws + WS_Z); const int lane = F.lane;
    for (int it = F.gw; it < MTOK * NH; it += F.NGW) { const int row = it >> 2, hd = it & 3;
        const GAS f32x4* hp = (const GAS f32x4*)(HH + (size_t)row * D + hd * 512 + 8 * lane); f32x4 x0 = hp[0], x1 = hp[1];
        const float mean = wave_sum((x0.x + x0.y) + (x0.z + x0.w) + (x1.x + x1.y) + (x1.z + x1.w)) * (1.f / 512.f);
        x0 = x0 - mean; x1 = x1 - mean;
        const float var = wave_sum((x0.x * x0.x + x0.y * x0.y) + (x0.z * x0.z + x0.w * x0.w) + (x1.x * x1.x + x1.y * x1.y) + (x1.z * x1.z + x1.w * x1.w)) * (1.f / 512.f);
        const float rstd = 1.f / sqrtf(var + LN_EPS);
        const GAS f32x4* gp = (const GAS f32x4*)(F.in[I_NG] + (size_t)j * D + hd * 512 + 8 * lane); const f32x4 g0 = gp[0], g1 = gp[1];
        const v4u oraw = *(const GAS v4u*)(QK + (size_t)row * NPM + 4096 + hd * 512 + 8 * lane);
        v4u o;
        o.x = pk2(sigmoidf_(bflo(oraw.x)) * x0.x * rstd * g0.x, sigmoidf_(bfhi(oraw.x)) * x0.y * rstd * g0.y);
        o.y = pk2(sigmoidf_(bflo(oraw.y)) * x0.z * rstd * g0.z, sigmoidf_(bfhi(oraw.y)) * x0.w * rstd * g0.w);
        o.z = pk2(sigmoidf_(bflo(oraw.z)) * x1.x * rstd * g1.x, sigmoidf_(bfhi(oraw.z)) * x1.y * rstd * g1.y);
        o.w = pk2(sigmoidf_(bflo(oraw.w)) * x1.z * rstd * g1.z, sigmoidf_(bfhi(oraw.w)) * x1.w * rstd * g1.w);
        *(GAS v4u*)(Z + (size_t)row * D + hd * 512 + 8 * lane) = o;
    }
}

template <bool ONE> __global__ void __launch_bounds__(NWAVES * 64, 2) trunk_fwd(Args args) {
    extern __shared__ __attribute__((aligned(16))) unsigned char lds[];
    LAS unsigned char* L = (LAS unsigned char*)lds;
    for (int u = threadIdx.x; u < (LDS_BYTES - LDSCTL_OFF) / 4; u += NWAVES * 64) ((LAS unsigned*)(L + LDSCTL_OFF))[u] = 0u;
    __syncthreads();
    XcdBarrier bar; bar.bar = (unsigned*)(args.ws + WS_CTL) + CW_BAR; bar.x = 0; bar.st = nullptr;
    const int lo = ONE ? 0 : args.seg_lo;
    if (ONE) bar = xcd_barrier_post((unsigned*)(args.ws + WS_CTL) + CW_BAR, (volatile LAS unsigned*)(L + MISC_OFF) + 8);
    int seg = 0;
#define SEAM() do { if (ONE) xcd_barrier(bar); else ++seg; } while (0)
#define ON (ONE || seg == lo)
#define FRAME() Frame F; do { int t_ = threadIdx.x; asm volatile("" : "+v"(t_)); F.lds = L; F.tid = t_; F.lane = t_ & 63; F.wave = __builtin_amdgcn_readfirstlane(t_ >> 6); F.G = gridDim.x; \
        F.gw = blockIdx.x * NWAVES + F.wave; F.NGW = F.G * NWAVES; const float* const __attribute__((address_space(4)))* ip_ = (const float* const __attribute__((address_space(4)))*)__builtin_amdgcn_kernarg_segment_ptr(); asm volatile("" : "+s"(ip_)); F.in = ip_; \
        float* o_ = args.out; asm volatile("" : "+s"(o_)); F.out = o_; unsigned char* w_ = args.ws; asm volatile("" : "+s"(w_)); F.ws = w_; } while (0)
#define GEMM(EPI, Aoff, Boff, NN, KK, ...) do { FRAME(); pg8::Gemm g{(const bf16*)(F.ws + (Aoff)), (const bf16*)(F.ws + (Boff)), MP, (NN), (KK)}; pg8::StaticOrder S; S.init(MP, (NN), F.G, (int)blockIdx.x); \
        pg8::EPI E{__VA_ARGS__}; pg8::gemm_phase<pg8::EPI, pg8::StaticOrder, true, true>(F.lds, g, S, E); } while (0)
    if (ON) { FRAME(); p0a(F); }
    SEAM();
    if (ON) { FRAME(); p0b(F); }
    SEAM();
    for (int hl = 0; hl < 8; ++hl) {
        const int li = hl >> 1, f = hl & 1;
        if (ON) GEMM(EpiSwiGLU, WS_XN, WS_WGU + (size_t)hl * 2 * DFF * D * 2, 2 * DFF, D, (bf16*)(F.ws + WS_H), DFF);
        SEAM();
        if (ON) GEMM(EpiRes, WS_H, WS_WD + (size_t)hl * D * DFF * 2, D, DFF, (const float*)(F.ws + WS_X), (float*)(F.ws + WS_Y), 0.5f);
        SEAM();
        if (f == 0) {
            if (ON) { FRAME(); if (li & 1) ln_phase<true, false>(F, li * 3 + 0, li >> 1); else ln_phase<false, false>(F, li * 3 + 0, 0); }
            SEAM();
            const int j = li >> 1;
            if (!(li & 1)) {
                if (ON) { FRAME(); s5a(F, j); }
                SEAM();
                if (ON) { FRAME(); s5b(F, j); }
                SEAM();
                if (ON) { FRAME(); s5c(F, j); }
                SEAM();
                if (ON) GEMM(EpiGLU, WS_Z, WS_WAB + (size_t)j * 2 * D * D * 2, 2 * D, D, (const float*)(F.ws + WS_X), (float*)(F.ws + WS_Y));
                SEAM();
            } else {
                if (ON) GEMM(EpiBf16, WS_XN, WS_WIN + (size_t)j * NPM * D * 2, NPM, D, (bf16*)(F.ws + WS_H), NPM);
                SEAM();
                if (ON) { FRAME(); mlstm_rec(F, j); }
                SEAM();
                if (ON) { FRAME(); mlstm_headnorm(F, j); }
                SEAM();
                if (ON) GEMM(EpiRes, WS_Z, WS_WOUT + (size_t)j * D * D * 2, D, D, (const float*)(F.ws + WS_X), (float*)(F.ws + WS_Y), 1.0f);
                SEAM();
            }
            if (ON) { FRAME(); ln_phase<false, false>(F, li * 3 + 1, 0); }
            SEAM();
        } else {
            if (ON) { FRAME(); if (hl == 7) ln_phase<false, true>(F, li * 3 + 2, 0); else ln_phase<false, false>(F, li * 3 + 2, 0); }
            SEAM();
        }
    }
#undef SEAM
#undef ON
#undef FRAME
#undef GEMM
}
constexpr int N_SEGS = 2 + 8 * 3 + 4 * 5;

extern "C" void kernel_launch(void* const* d_in, const int* in_sizes, int n_in, void* d_out, int out_size, void* d_ws, size_t ws_size, hipStream_t stream) {
    static int grid = 0;
    if (grid == 0) {
        if (n_in != 27 || (size_t)out_size != O_END || ws_size < WS_END) { fprintf(stderr, "kernel_launch: unexpected sizes n_in %d out %d ws %zu\n", n_in, out_size, ws_size); grid = -1; return; }
        int dev = 0, cus = 0, per_cu = 0;
        if (hipGetDevice(&dev) != hipSuccess || hipDeviceGetAttribute(&cus, hipDeviceAttributeMultiprocessorCount, dev) != hipSuccess) { grid = -1; return; }
        if (hipFuncSetAttribute((const void*)trunk_fwd<MK_ONE_LAUNCH != 0>, hipFuncAttributeMaxDynamicSharedMemorySize, LDS_BYTES) != hipSuccess) { fprintf(stderr, "kernel_launch: hipFuncSetAttribute failed\n"); grid = -1; return; }
        if (hipOccupancyMaxActiveBlocksPerMultiprocessor(&per_cu, (const void*)trunk_fwd<MK_ONE_LAUNCH != 0>, NWAVES * 64, LDS_BYTES) != hipSuccess || per_cu < 1) fprintf(stderr, "kernel_launch: occupancy query says %d\n", per_cu);
        (void)hipGetLastError();
        grid = cus;
    }
    if (grid < 0) return;
    if (hipMemsetAsync((char*)d_ws + WS_CTL, 0, CTL_ZERO_BYTES, stream) != hipSuccess) return;
    Args a{};
    for (int i = 0; i < 27; ++i) a.in[i] = (const float*)d_in[i];
    a.out = (float*)d_out; a.ws = (unsigned char*)d_ws; a.pad = 0;
#if MK_ONE_LAUNCH
    a.seg_lo = 0; a.seg_hi = 1 << 30; a.one = 1;
    hipLaunchKernelGGL(trunk_fwd<MK_ONE_LAUNCH != 0>, dim3(grid), dim3(NWAVES * 64), LDS_BYTES, stream, a);
#else
    for (int s = 0; s < N_SEGS; ++s) { a.seg_lo = s; a.seg_hi = s + 1; a.one = 0; hipLaunchKernelGGL(trunk_fwd<MK_ONE_LAUNCH != 0>, dim3(grid), dim3(NWAVES * 64), LDS_BYTES, stream, a); }
#endif
}
```
